# Optimizing an MI355X kernel written in HIP

```python
import math
import functools
import jax
import jax.numpy as jnp
from jax import lax
import numpy as np


D_MODEL = 1024
BATCH = 2
SEQ = 8192
DEPTH = 2

MLSTM_HEADS = 4
MLSTM_QK_DIM = 64
MLSTM_V_DIM = 128
MLSTM_CHUNK = 128
ATTN_HEADS = 8
ATTN_HEAD_DIM = 64
DILATED_BRANCHES = ((128, 1), (512, 4), (2048, 16))
ATTN_BLOCK = 128
REL_BUCKETS = 32
REL_MAX_DIST = 2048
CONV_CH = 512
CONV_K = 3
SGU_CH = 512
SGU_GROUPS = 4
SGU_GROUP_CH = SGU_CH // SGU_GROUPS
SGU_CHUNK = 128
D_FF = 2816
FFN_RES_W = 0.5
LN_EPS = 1e-5
DEEPNORM_ALPHA = (2 * DEPTH) ** 0.25
DEEPNORM_BETA = (8 * DEPTH) ** -0.25
N_EVEN = (DEPTH + 1) // 2
N_ODD = DEPTH // 2
MLSTM_QK_W = MLSTM_HEADS * MLSTM_QK_DIM
MLSTM_V_W = MLSTM_HEADS * MLSTM_V_DIM
ATTN_W = ATTN_HEADS * ATTN_HEAD_DIM
AB_SPLITS = (MLSTM_QK_W, MLSTM_QK_W, MLSTM_V_W, MLSTM_V_W, MLSTM_HEADS, MLSTM_HEADS, ATTN_W, ATTN_W, ATTN_W)
AB_IN_W = sum(AB_SPLITS)
AB_MIX_W = MLSTM_V_W + ATTN_W
CD_SPLITS = (CONV_CH, CONV_CH, CONV_CH, SGU_CH, SGU_CH)
CD_IN_W = sum(CD_SPLITS)
CD_MIX_W = CONV_CH + SGU_CH

kernel_name = 'hybrid_mlstm_dilated_shortconv_sgu_macaron'


def _split_cols(z, sizes):
    idx = np.cumsum(sizes)[:-1].tolist()
    return jnp.split(z, idx, axis=-1)


def layer_norm(x, g, b):
    xf = x.astype(jnp.float32)
    mu = jnp.mean(xf, axis=-1, keepdims=True)
    var = jnp.mean(jnp.square(xf - mu), axis=-1, keepdims=True)
    return ((xf - mu) * lax.rsqrt(var + LN_EPS) * g + b).astype(x.dtype)


def swiglu(h, w_gate, w_up, w_down):
    return (jax.nn.silu(h @ w_gate) * (h @ w_up)) @ w_down


def rel_bucket(dist):
    max_exact = REL_BUCKETS // 2
    d = jnp.maximum(dist, 0)
    large = max_exact + (jnp.log(jnp.maximum(d, 1).astype(jnp.float32) / max_exact)
                         / math.log(REL_MAX_DIST / max_exact) * (REL_BUCKETS - max_exact)).astype(jnp.int32)
    large = jnp.minimum(large, REL_BUCKETS - 1)
    return jnp.where(d < max_exact, d, large)


def mlstm_chunkwise(q, k, v, i_pre, f_pre):
    B, S, H, DK = q.shape
    DV = v.shape[-1]
    L = MLSTM_CHUNK
    NC = S // L
    f32 = jnp.float32
    q = q.astype(f32).reshape(B, NC, L, H, DK)
    k = (k.astype(f32) * DK ** -0.5).reshape(B, NC, L, H, DK)
    v = v.astype(f32).reshape(B, NC, L, H, DV)
    log_i = i_pre.astype(f32).reshape(B, NC, L, H).transpose(0, 1, 3, 2)
    log_f = jax.nn.log_sigmoid(f_pre.astype(f32)).reshape(B, NC, L, H).transpose(0, 1, 3, 2)
    cum_f = jnp.cumsum(log_f, axis=-1)
    causal = jnp.tril(jnp.ones((L, L), dtype=bool))
    d_log = jnp.where(causal, cum_f[..., :, None] - cum_f[..., None, :] + log_i[..., None, :], -jnp.inf)
    chunk_f = cum_f[..., -1]
    g = chunk_f[..., None] - cum_f + log_i
    g_max = jnp.max(g, axis=-1)

    def step(carry, xs):
        C, n, m = carry
        g_c, gmax_c, f_c, k_c, v_c = xs
        m_new = jnp.maximum(f_c + m, gmax_c)
        decay = jnp.exp(f_c + m - m_new)
        w = jnp.exp(g_c - m_new[..., None])
        C_new = decay[..., None, None] * C + jnp.einsum('bhl,blhk,blhv->bhkv', w, k_c, v_c)
        n_new = decay[..., None] * n + jnp.einsum('bhl,blhk->bhk', w, k_c)
        return (C_new, n_new, m_new), (C, n, m)

    init = (jnp.zeros((B, H, DK, DV), f32), jnp.zeros((B, H, DK), f32), jnp.zeros((B, H), f32))
    xs = (jnp.moveaxis(g, 1, 0), jnp.moveaxis(g_max, 1, 0), jnp.moveaxis(chunk_f, 1, 0),
          jnp.moveaxis(k, 1, 0), jnp.moveaxis(v, 1, 0))
    _, (C_prev, n_prev, m_prev) = lax.scan(step, init, xs)
    C_prev = jnp.moveaxis(C_prev, 0, 1)
    n_prev = jnp.moveaxis(n_prev, 0, 1)
    m_prev = jnp.moveaxis(m_prev, 0, 1)
    inter_log = cum_f + m_prev[..., None]
    m_t = jnp.maximum(inter_log, jnp.max(d_log, axis=-1))
    w_intra = jnp.exp(d_log - m_t[..., None]) * jnp.einsum('bcthk,bcshk->bchts', q, k)
    w_inter = jnp.exp(inter_log - m_t)
    num = (jnp.einsum('bchts,bcshv->bcthv', w_intra, v)
           + jnp.einsum('bcthk,bchkv->bcthv', q, C_prev) * w_inter.transpose(0, 1, 3, 2)[..., None])
    den = jnp.sum(w_intra, axis=-1) + jnp.einsum('bcthk,bchk->bcht', q, n_prev) * w_inter
    den = jnp.maximum(jnp.abs(den), jnp.exp(-m_t))
    h = num / den.transpose(0, 1, 3, 2)[..., None]
    return h.reshape(B, S, H, DV)


def dilated_branch(q, k, v, rel_bias, window, dilation):
    B, S, H, Dh = q.shape
    L = S // dilation
    span = window // dilation
    blk = ATTN_BLOCK
    nb = -(-L // blk)
    Lp = nb * blk

    def to_sub(t):
        t = t.reshape(B, L, dilation, H, Dh).transpose(0, 2, 1, 3, 4)
        return jnp.pad(t, ((0, 0), (0, 0), (0, Lp - L), (0, 0), (0, 0)))

    def windows(t):
        t = jnp.pad(t, ((0, 0), (0, 0), (blk, 0), (0, 0), (0, 0))).reshape(B, dilation, nb + 1, blk, H, Dh)
        return jnp.concatenate([t[:, :, :-1], t[:, :, 1:]], axis=3)

    qb = to_sub(q).reshape(B, dilation, nb, blk, H, Dh)
    kw = windows(to_sub(k))
    vw = windows(to_sub(v))
    qi = jnp.arange(blk)[:, None]
    kj = jnp.arange(2 * blk)[None, :]
    dist = qi + blk - kj
    key_idx = jnp.arange(nb)[:, None, None] * blk - blk + kj[None]
    valid = (dist >= 0) & (dist <= span) & (key_idx >= 0)
    bias = rel_bias[rel_bucket(dist * dilation)].transpose(2, 0, 1).astype(jnp.float32)
    s = jnp.einsum('brnqhd,brnkhd->brnhqk', qb, kw, preferred_element_type=jnp.float32) * (Dh ** -0.5)
    s = jnp.where(valid[None, None, :, None], s + bias, -1e30)
    m = jnp.max(s, axis=-1, keepdims=True)
    p = jnp.exp(s - m)
    l = jnp.sum(p, axis=-1, keepdims=True)
    o = jnp.einsum('brnhqk,brnkhd->brnhqd', p, vw.astype(jnp.float32)) / l
    lse = (m + jnp.log(l))[..., 0]
    o = o.transpose(0, 1, 2, 4, 3, 5).reshape(B, dilation, Lp, H, Dh)[:, :, :L]
    o = o.transpose(0, 2, 1, 3, 4).reshape(B, S, H, Dh)
    lse = lse.transpose(0, 1, 2, 4, 3).reshape(B, dilation, Lp, H)[:, :, :L]
    lse = lse.transpose(0, 2, 1, 3).reshape(B, S, H)
    return o, lse


def dilated_attention(q, k, v, rel_bias):
    outs, lses = [], []
    for window, dilation in DILATED_BRANCHES:
        o, lse = dilated_branch(q, k, v, rel_bias, window, dilation)
        outs.append(o)
        lses.append(lse)
    w = jax.nn.softmax(jnp.stack(lses, axis=0), axis=0)
    return jnp.einsum('gbsh,gbshd->bshd', w, jnp.stack(outs, axis=0))


def mixer_mlstm_dilated(h, w_in, w_out, b_igate, b_fgate, rel_bias):
    B, S, _ = h.shape
    z = h @ w_in
    mq, mk, mv, mo, mi, mf, aq, ak, av = _split_cols(z, AB_SPLITS)
    h_a = mlstm_chunkwise(mq.reshape(B, S, MLSTM_HEADS, MLSTM_QK_DIM), mk.reshape(B, S, MLSTM_HEADS, MLSTM_QK_DIM),
                          mv.reshape(B, S, MLSTM_HEADS, MLSTM_V_DIM), mi + b_igate, mf + b_fgate)
    h_a = jax.nn.sigmoid(mo.astype(jnp.float32)) * h_a.reshape(B, S, MLSTM_V_W)
    h_b = dilated_attention(aq.reshape(B, S, ATTN_HEADS, ATTN_HEAD_DIM), ak.reshape(B, S, ATTN_HEADS, ATTN_HEAD_DIM),
                            av.reshape(B, S, ATTN_HEADS, ATTN_HEAD_DIM), rel_bias).reshape(B, S, ATTN_W)
    return jnp.concatenate([h_a, h_b], axis=-1).astype(h.dtype) @ w_out


def causal_depthwise_conv(u, w, b):
    K, C = w.shape
    y = lax.conv_general_dilated(u, w[:, None, :].astype(u.dtype), window_strides=(1,), padding=[(K - 1, 0)],
                                 dimension_numbers=('NWC', 'WIO', 'NWC'), feature_group_count=C)
    return y + b


def mixer_shortconv_sgu(h, w_in, w_out, conv_w, conv_b, sgu_ln_g, sgu_ln_b, sgu_w, sgu_b):
    B, S, _ = h.shape
    z = h @ w_in
    gate_b, gate_c, xc, u, v = _split_cols(z, CD_SPLITS)
    y_c = gate_b * causal_depthwise_conv(gate_c * xc, conv_w, conv_b)
    u = jax.nn.gelu(u)
    v = jax.nn.gelu(v).reshape(B, S, SGU_GROUPS, SGU_GROUP_CH)
    v = layer_norm(v, sgu_ln_g, sgu_ln_b)
    v = v.reshape(B, S // SGU_CHUNK, SGU_CHUNK, SGU_GROUPS, SGU_GROUP_CH)
    w_s = jnp.where(jnp.tril(jnp.ones((SGU_CHUNK, SGU_CHUNK), dtype=bool)), sgu_w, 0.0)
    mixed = jnp.einsum('gts,bnsgc->bntgc', w_s.astype(v.dtype), v) + sgu_b.T[:, :, None]
    y_d = u * mixed.reshape(B, S, SGU_CH)
    return jnp.concatenate([y_c, y_d], axis=-1) @ w_out


def _ada_post_norm(x, mod, fn, ln_g, ln_b, res_w):
    shift, scale, gate = mod[:, 0, None], mod[:, 1, None], mod[:, 2, None]
    y = fn(x * (1 + scale) + shift)
    return layer_norm(DEEPNORM_ALPHA * x + res_w * (1 + gate) * y, ln_g, ln_b)


def setup_inputs(seed: int = 0) -> dict:
    key = jax.random.key(seed)
    ks = jax.random.split(key, 24)
    f32 = jnp.float32
    D = D_MODEL

    def nrm(k, shape, s):
        return jax.random.normal(k, shape, f32) * s

    return {
        'x': nrm(ks[0], (BATCH, SEQ, D), 1.0),
        'c': nrm(ks[1], (BATCH, D), 1.0),
        'rel_bias': nrm(ks[2], (REL_BUCKETS, ATTN_HEADS), 0.5),
        'ada_w': nrm(ks[3], (DEPTH, D, 9 * D), 0.2 * D ** -0.5),
        'ada_b': nrm(ks[4], (DEPTH, 9 * D), 0.02),
        'ln_g': 1.0 + nrm(ks[5], (DEPTH, 3, D), 0.02),
        'ln_b': nrm(ks[6], (DEPTH, 3, D), 0.02),
        'ffn_w_gate': nrm(ks[7], (DEPTH, 2, D, D_FF), D ** -0.5),
        'ffn_w_up': nrm(ks[8], (DEPTH, 2, D, D_FF), D ** -0.5),
        'ffn_w_down': nrm(ks[9], (DEPTH, 2, D_FF, D), DEEPNORM_BETA * D_FF ** -0.5),
        'ab_w_in': nrm(ks[10], (N_EVEN, D, AB_IN_W), D ** -0.5),
        'ab_w_out': nrm(ks[11], (N_EVEN, AB_MIX_W, D), DEEPNORM_BETA * AB_MIX_W ** -0.5),
        'ab_b_igate': nrm(ks[12], (N_EVEN, MLSTM_HEADS), 0.1),
        'ab_b_fgate': jnp.linspace(3.0, 6.0, MLSTM_HEADS, dtype=f32)[None] + nrm(ks[13], (N_EVEN, MLSTM_HEADS), 0.1),
        'cd_w_in': nrm(ks[14], (N_ODD, D, CD_IN_W), D ** -0.5),
        'cd_w_out': nrm(ks[15], (N_ODD, CD_MIX_W, D), DEEPNORM_BETA * CD_MIX_W ** -0.5),
        'cd_conv_w': nrm(ks[16], (N_ODD, CONV_K, CONV_CH), CONV_K ** -0.5),
        'cd_conv_b': nrm(ks[17], (N_ODD, CONV_CH), 0.02),
        'cd_sgu_ln_g': 1.0 + nrm(ks[18], (N_ODD, SGU_GROUPS, SGU_GROUP_CH), 0.02),
        'cd_sgu_ln_b': nrm(ks[19], (N_ODD, SGU_GROUPS, SGU_GROUP_CH), 0.02),
        'cd_sgu_w': nrm(ks[20], (N_ODD, SGU_GROUPS, SGU_CHUNK, SGU_CHUNK), SGU_CHUNK ** -0.5),
        'cd_sgu_b': 1.0 + nrm(ks[21], (N_ODD, SGU_GROUPS, SGU_CHUNK), 0.1),
    }


def reference(x, c, rel_bias, ada_w, ada_b, ln_g, ln_b, ffn_w_gate, ffn_w_up, ffn_w_down,
              ab_w_in, ab_w_out, ab_b_igate, ab_b_fgate,
              cd_w_in, cd_w_out, cd_conv_w, cd_conv_b, cd_sgu_ln_g, cd_sgu_ln_b, cd_sgu_w, cd_sgu_b):
    B = x.shape[0]
    for layer in range(DEPTH):
        mod = (jax.nn.silu(c) @ ada_w[layer] + ada_b[layer]).reshape(B, 3, 3, D_MODEL)
        ffn_pre = functools.partial(swiglu, w_gate=ffn_w_gate[layer, 0], w_up=ffn_w_up[layer, 0], w_down=ffn_w_down[layer, 0])
        ffn_post = functools.partial(swiglu, w_gate=ffn_w_gate[layer, 1], w_up=ffn_w_up[layer, 1], w_down=ffn_w_down[layer, 1])
        if layer % 2 == 0:
            e = layer // 2
            mix = functools.partial(mixer_mlstm_dilated, w_in=ab_w_in[e], w_out=ab_w_out[e],
                                    b_igate=ab_b_igate[e], b_fgate=ab_b_fgate[e], rel_bias=rel_bias)
        else:
            o = layer // 2
            mix = functools.partial(mixer_shortconv_sgu, w_in=cd_w_in[o], w_out=cd_w_out[o], conv_w=cd_conv_w[o],
                                    conv_b=cd_conv_b[o], sgu_ln_g=cd_sgu_ln_g[o], sgu_ln_b=cd_sgu_ln_b[o],
                                    sgu_w=cd_sgu_w[o], sgu_b=cd_sgu_b[o])
        x = _ada_post_norm(x, mod[:, 0], ffn_pre, ln_g[layer, 0], ln_b[layer, 0], FFN_RES_W)
        x = _ada_post_norm(x, mod[:, 1], mix, ln_g[layer, 1], ln_b[layer, 1], 1.0)
        x = _ada_post_norm(x, mod[:, 2], ffn_post, ln_g[layer, 2], ln_b[layer, 2], FFN_RES_W)
    return x
```

```cpp
#include <hip/hip_runtime.h>
#include <cstdio>
#include <cstdint>
#include <cmath>

constexpr int DM = 1024, NB = 2, SQ = 8192, DFF = 2816;
constexpr int ABW = 3080, CDW = 2560;
constexpr float ALPHA = 1.41421356237309515f;
constexpr float LN_EPS = 1e-5f;

__device__ __forceinline__ float siluf(float x) { return x / (1.f + expf(-x)); }
__device__ __forceinline__ float sigmf(float x) { return 1.f / (1.f + expf(-x)); }
__device__ __forceinline__ float gelu_tanh(float x) { const float u = 0.7978845608028654f * (x + 0.044715f * x * x * x); return 0.5f * x * (1.f + tanhf(u)); }
__device__ __forceinline__ int rel_bucket(int n) {
    if (n < 16) return n;
    int b = 16;
    b += (n >= 22); b += (n >= 30); b += (n >= 40); b += (n >= 54); b += (n >= 73); b += (n >= 99); b += (n >= 134); b += (n >= 182);
    b += (n >= 246); b += (n >= 332); b += (n >= 450); b += (n >= 609); b += (n >= 825); b += (n >= 1117); b += (n >= 1513);
    return b;
}

__global__ void mod_kernel(const float* c, const float* ada_w, const float* ada_b, float* mod) {
    const int idx = blockIdx.x * blockDim.x + threadIdx.x;
    if (idx >= 2 * NB * 9 * DM) return;
    const int j = idx % (9 * DM), b = (idx / (9 * DM)) % NB, l = idx / (9 * DM * NB);
    const float* w = ada_w + (size_t)l * DM * 9 * DM + j;
    float acc = 0.f;
    for (int k = 0; k < DM; ++k) acc += siluf(c[b * DM + k]) * w[(size_t)k * 9 * DM];
    mod[idx] = acc + ada_b[l * 9 * DM + j];
}

__global__ void modulate_kernel(const float* x, const float* shift, const float* scale, float* h, int rows) {
    const size_t idx = (size_t)blockIdx.x * blockDim.x + threadIdx.x;
    if (idx >= (size_t)rows * DM) return;
    const int d = idx % DM;
    h[idx] = x[idx] * (1.f + scale[d]) + shift[d];
}

template <int MODE>
__global__ __launch_bounds__(256) void gemm_naive(const float* A, int lda, const float* Bm, const float* B2, int ldb, float* C, int ldc, int M, int N, int K) {
    __shared__ float As[16][68];
    __shared__ float Bs[16][68];
    __shared__ float B2s[16][68];
    const int tid = threadIdx.x, tx = tid & 15, ty = tid >> 4;
    const int m0 = blockIdx.y * 64, n0 = blockIdx.x * 64;
    float acc[4][4], acc2[4][4];
#pragma unroll
    for (int i = 0; i < 4; ++i)
#pragma unroll
        for (int j = 0; j < 4; ++j) { acc[i][j] = 0.f; acc2[i][j] = 0.f; }
    for (int k0 = 0; k0 < K; k0 += 16) {
        {
            const int r = tid >> 2, kk = (tid & 3) * 4;
            const float4 v = *(const float4*)&A[(size_t)(m0 + r) * lda + k0 + kk];
            As[kk + 0][r] = v.x; As[kk + 1][r] = v.y; As[kk + 2][r] = v.z; As[kk + 3][r] = v.w;
        }
        {
            const int kk = tid >> 4, nn = (tid & 15) * 4;
#pragma unroll
            for (int j = 0; j < 4; ++j) {
                const int n = n0 + nn + j;
                Bs[kk][nn + j] = n < N ? Bm[(size_t)(k0 + kk) * ldb + n] : 0.f;
                if (MODE == 1) B2s[kk][nn + j] = n < N ? B2[(size_t)(k0 + kk) * ldb + n] : 0.f;
            }
        }
        __syncthreads();
#pragma unroll
        for (int kk = 0; kk < 16; ++kk) {
            float a[4], b[4], b2[4];
#pragma unroll
            for (int i = 0; i < 4; ++i) a[i] = As[kk][ty * 4 + i];
#pragma unroll
            for (int j = 0; j < 4; ++j) { b[j] = Bs[kk][tx * 4 + j]; if (MODE == 1) b2[j] = B2s[kk][tx * 4 + j]; }
#pragma unroll
            for (int i = 0; i < 4; ++i)
#pragma unroll
                for (int j = 0; j < 4; ++j) { acc[i][j] += a[i] * b[j]; if (MODE == 1) acc2[i][j] += a[i] * b2[j]; }
        }
        __syncthreads();
    }
#pragma unroll
    for (int i = 0; i < 4; ++i)
#pragma unroll
        for (int j = 0; j < 4; ++j) {
            const int m = m0 + ty * 4 + i, n = n0 + tx * 4 + j;
            if (n < N) C[(size_t)m * ldc + n] = (MODE == 1) ? siluf(acc[i][j]) * acc2[i][j] : acc[i][j];
        }
}

__global__ __launch_bounds__(256) void resid_ln_kernel(const float* xin, const float* y, const float* gate, const float* g, const float* bb, float rw, float* xout) {
    __shared__ float red[8];
    const int row = blockIdx.x, tid = threadIdx.x;
    float z[4];
    float s = 0.f;
#pragma unroll
    for (int i = 0; i < 4; ++i) { const int d = tid + i * 256; z[i] = ALPHA * xin[(size_t)row * DM + d] + rw * (1.f + gate[d]) * y[(size_t)row * DM + d]; s += z[i]; }
    for (int o = 32; o > 0; o >>= 1) s += __shfl_xor(s, o);
    if ((tid & 63) == 0) red[tid >> 6] = s;
    __syncthreads();
    const float mean = (red[0] + red[1] + red[2] + red[3]) * (1.f / DM);
    float q = 0.f;
#pragma unroll
    for (int i = 0; i < 4; ++i) { const float dlt = z[i] - mean; q += dlt * dlt; }
    for (int o = 32; o > 0; o >>= 1) q += __shfl_xor(q, o);
    if ((tid & 63) == 0) red[4 + (tid >> 6)] = q;
    __syncthreads();
    const float var = (red[4] + red[5] + red[6] + red[7]) * (1.f / DM);
    const float rstd = 1.f / sqrtf(var + LN_EPS);
#pragma unroll
    for (int i = 0; i < 4; ++i) { const int d = tid + i * 256; xout[(size_t)row * DM + d] = (z[i] - mean) * rstd * g[d] + bb[d]; }
}

__global__ __launch_bounds__(192) void mlstm_naive(const float* Z, const float* b_i, const float* b_f, float* num, float* den) {
    const int h = blockIdx.x, col = threadIdx.x;
    if (col > 128) return;
    double C[64];
#pragma unroll
    for (int k = 0; k < 64; ++k) C[k] = 0.0;
    const float bi = b_i[h], bf = b_f[h];
    for (int t = 0; t < SQ; ++t) {
        const float* z = Z + (size_t)t * ABW;
        const float ip = z[1536 + h] + bi, fp = z[1540 + h] + bf;
        const double f = 1.0 / (1.0 + exp(-(double)fp));
        const double ig = exp((double)ip);
        const double v = col < 128 ? (double)z[512 + h * 128 + col] : 1.0;
        const double iv = ig * v;
        double acc = 0.0;
#pragma unroll
        for (int k = 0; k < 64; ++k) { const double kk = (double)z[256 + h * 64 + k] * 0.125; C[k] = f * C[k] + iv * kk; acc += C[k] * (double)z[h * 64 + k]; }
        if (col < 128) num[(size_t)t * 512 + h * 128 + col] = (float)acc; else den[t * 4 + h] = (float)acc;
    }
}
__global__ void mlstm_out_kernel(const float* Z, const float* num, const float* den, float* MIX) {
    const int idx = blockIdx.x * blockDim.x + threadIdx.x;
    if (idx >= SQ * 512) return;
    const int t = idx / 512, c = idx % 512, h = c / 128;
    const float dn = fmaxf(fabsf(den[t * 4 + h]), 1.f);
    MIX[(size_t)t * DM + c] = sigmf(Z[(size_t)t * ABW + 1024 + c]) * num[idx] / dn;
}

__global__ __launch_bounds__(64) void attn_naive(const float* Z, const float* rel_bias, float* MIX) {
    const int idx = blockIdx.x * blockDim.x + threadIdx.x;
    const int t = idx % SQ, h = idx / SQ;
    float q[64], o[64];
    const float* qp = Z + (size_t)t * ABW + 1544 + h * 64;
#pragma unroll
    for (int d = 0; d < 64; ++d) { q[d] = qp[d]; o[d] = 0.f; }
    float m = -1e30f, l = 0.f;
    for (int br = 0; br < 3; ++br) {
        const int dil = br == 0 ? 1 : (br == 1 ? 4 : 16);
        for (int j = 0; j <= 128; ++j) {
            const int tk = t - j * dil;
            if (tk < 0) break;
            const float* kp = Z + (size_t)tk * ABW + 2056 + h * 64;
            const float* vp = Z + (size_t)tk * ABW + 2568 + h * 64;
            float s = 0.f;
#pragma unroll
            for (int d = 0; d < 64; ++d) s += q[d] * kp[d];
            s = s * 0.125f + rel_bias[rel_bucket(j * dil) * 8 + h];
            const float mn = fmaxf(m, s);
            const float corr = expf(m - mn), p = expf(s - mn);
            l = l * corr + p;
#pragma unroll
            for (int d = 0; d < 64; ++d) o[d] = o[d] * corr + p * vp[d];
            m = mn;
        }
    }
    const float inv = 1.f / l;
#pragma unroll
    for (int d = 0; d < 64; ++d) MIX[(size_t)t * DM + 512 + h * 64 + d] = o[d] * inv;
}

__global__ void conv_kernel(const float* Z, const float* cw, const float* cb, float* MIX) {
    const int idx = blockIdx.x * blockDim.x + threadIdx.x;
    if (idx >= SQ * 512) return;
    const int t = idx / 512, c = idx % 512;
    float acc = cb[c];
#pragma unroll
    for (int k = 0; k < 3; ++k) { const int tt = t - 2 + k; if (tt >= 0) acc += cw[k * 512 + c] * Z[(size_t)tt * CDW + 512 + c] * Z[(size_t)tt * CDW + 1024 + c]; }
    MIX[(size_t)t * DM + c] = Z[(size_t)t * CDW + c] * acc;
}
__global__ __launch_bounds__(128) void sgu_prep_kernel(const float* Z, const float* lg, const float* lb, float* VN) {
    __shared__ float red[4];
    const int t = blockIdx.x / 4, g = blockIdx.x % 4, c = threadIdx.x;
    const float v = gelu_tanh(Z[(size_t)t * CDW + 2048 + g * 128 + c]);
    float s = v;
    for (int o = 32; o > 0; o >>= 1) s += __shfl_xor(s, o);
    if ((c & 63) == 0) red[c >> 6] = s;
    __syncthreads();
    const float mean = (red[0] + red[1]) * (1.f / 128.f);
    const float dlt = v - mean;
    float q = dlt * dlt;
    for (int o = 32; o > 0; o >>= 1) q += __shfl_xor(q, o);
    if ((c & 63) == 0) red[2 + (c >> 6)] = q;
    __syncthreads();
    const float rstd = 1.f / sqrtf((red[2] + red[3]) * (1.f / 128.f) + LN_EPS);
    VN[(size_t)t * 512 + g * 128 + c] = dlt * rstd * lg[g * 128 + c] + lb[g * 128 + c];
}
__global__ void sgu_mix_kernel(const float* Z, const float* VN, const float* sw, const float* sb, float* MIX) {
    const int idx = blockIdx.x * blockDim.x + threadIdx.x;
    if (idx >= SQ * 512) return;
    const int t = idx / 512, col = idx % 512, g = col / 128, n = t / 128, tt = t % 128;
    float acc = sb[g * 128 + tt];
    for (int s = 0; s <= tt; ++s) acc += sw[(g * 128 + tt) * 128 + s] * VN[(size_t)(n * 128 + s) * 512 + col];
    MIX[(size_t)t * DM + 512 + col] = gelu_tanh(Z[(size_t)t * CDW + 1536 + col]) * acc;
}

extern "C" void kernel_launch(void* const* d_in, const int* in_sizes, int n_in, void* d_out, int out_size, void* d_ws, size_t ws_size, hipStream_t stream) {
    const float* x = (const float*)d_in[0];
    const float* c = (const float*)d_in[1];
    const float* rel_bias = (const float*)d_in[2];
    const float* ada_w = (const float*)d_in[3];
    const float* ada_b = (const float*)d_in[4];
    const float* ln_g = (const float*)d_in[5];
    const float* ln_b = (const float*)d_in[6];
    const float* w_gate = (const float*)d_in[7];
    const float* w_up = (const float*)d_in[8];
    const float* w_down = (const float*)d_in[9];
    const float* ab_w_in = (const float*)d_in[10];
    const float* ab_w_out = (const float*)d_in[11];
    const float* ab_bi = (const float*)d_in[12];
    const float* ab_bf = (const float*)d_in[13];
    const float* cd_w_in = (const float*)d_in[14];
    const float* cd_w_out = (const float*)d_in[15];
    const float* cd_cw = (const float*)d_in[16];
    const float* cd_cb = (const float*)d_in[17];
    const float* cd_lg = (const float*)d_in[18];
    const float* cd_lb = (const float*)d_in[19];
    const float* cd_sw = (const float*)d_in[20];
    const float* cd_sb = (const float*)d_in[21];
    float* out = (float*)d_out;
    char* ws = (char*)d_ws;
    size_t off = 0;
    auto carve = [&](size_t bytes) { char* p = ws + off; off += (bytes + 255) & ~(size_t)255; return (float*)p; };
    float* mod = carve((size_t)2 * NB * 9 * DM * 4);
    float* HB = carve((size_t)SQ * DM * 4);
    float* BIG = carve((size_t)SQ * ABW * 4);
    float* MIX = carve((size_t)SQ * DM * 4);
    float* NUM = carve((size_t)SQ * 512 * 4);
    float* DEN = carve((size_t)SQ * 4 * 4);
    if (off > ws_size) { fprintf(stderr, "ws too small: need %zu have %zu\n", off, ws_size); return; }

    mod_kernel<<<(2 * NB * 9 * DM + 255) / 256, 256, 0, stream>>>(c, ada_w, ada_b, mod);
    const int R = SQ;
    for (int b = 0; b < NB; ++b) {
        const float* xin = x + (size_t)b * SQ * DM;
        float* X = out + (size_t)b * SQ * DM;
        for (int l = 0; l < 2; ++l) {
            for (int sub = 0; sub < 3; ++sub) {
                const float* md = mod + ((size_t)(l * NB + b) * 9 + sub * 3) * DM;
                const float *shift = md, *scale = md + DM, *gate = md + 2 * DM;
                const float* xsrc = (l == 0 && sub == 0) ? xin : X;
                modulate_kernel<<<(R * DM + 255) / 256, 256, 0, stream>>>(xsrc, shift, scale, HB, R);
                float rw;
                if (sub != 1) {
                    const int s = sub == 0 ? 0 : 1;
                    const float* wg = w_gate + (size_t)(l * 2 + s) * DM * DFF;
                    const float* wu = w_up + (size_t)(l * 2 + s) * DM * DFF;
                    const float* wd = w_down + (size_t)(l * 2 + s) * DFF * DM;
                    gemm_naive<1><<<dim3(DFF / 64, R / 64), 256, 0, stream>>>(HB, DM, wg, wu, DFF, BIG, DFF, R, DFF, DM);
                    gemm_naive<0><<<dim3(DM / 64, R / 64), 256, 0, stream>>>(BIG, DFF, wd, nullptr, DM, HB, DM, R, DM, DFF);
                    rw = 0.5f;
                } else if (l == 0) {
                    gemm_naive<0><<<dim3((ABW + 63) / 64, R / 64), 256, 0, stream>>>(HB, DM, ab_w_in, nullptr, ABW, BIG, ABW, R, ABW, DM);
                    mlstm_naive<<<4, 192, 0, stream>>>(BIG, ab_bi, ab_bf, NUM, DEN);
                    mlstm_out_kernel<<<(SQ * 512 + 255) / 256, 256, 0, stream>>>(BIG, NUM, DEN, MIX);
                    attn_naive<<<SQ * 8 / 64, 64, 0, stream>>>(BIG, rel_bias, MIX);
                    gemm_naive<0><<<dim3(DM / 64, R / 64), 256, 0, stream>>>(MIX, DM, ab_w_out, nullptr, DM, HB, DM, R, DM, DM);
                    rw = 1.0f;
                } else {
                    gemm_naive<0><<<dim3(CDW / 64, R / 64), 256, 0, stream>>>(HB, DM, cd_w_in, nullptr, CDW, BIG, CDW, R, CDW, DM);
                    conv_kernel<<<(SQ * 512 + 255) / 256, 256, 0, stream>>>(BIG, cd_cw, cd_cb, MIX);
                    sgu_prep_kernel<<<SQ * 4, 128, 0, stream>>>(BIG, cd_lg, cd_lb, NUM);
                    sgu_mix_kernel<<<(SQ * 512 + 255) / 256, 256, 0, stream>>>(BIG, NUM, cd_sw, cd_sb, MIX);
                    gemm_naive<0><<<dim3(DM / 64, R / 64), 256, 0, stream>>>(MIX, DM, cd_w_out, nullptr, DM, HB, DM, R, DM, DM);
                    rw = 1.0f;
                }
                resid_ln_kernel<<<R, 256, 0, stream>>>(xsrc, HB, gate, ln_g + (l * 3 + sub) * DM, ln_b + (l * 3 + sub) * DM, rw, X);
            }
        }
    }
}
```
